# Optimizing an MI355X kernel written in HIP

```python
import math
import jax, jax.numpy as jnp
from jax import lax
import numpy as np

D_MODEL = 1024
BATCH = 4
SEQ = 4096
DEPTH = 1

N_META = 16
HEAD_DIM = 64
SWA_Q_HEADS = D_MODEL // (2 * HEAD_DIM)
SWA_KV_HEADS = max(SWA_Q_HEADS // 4, 1)
SWA_GROUP = SWA_Q_HEADS // SWA_KV_HEADS
FOX_HEADS = D_MODEL // (2 * HEAD_DIM)
SWA_Q_W = SWA_Q_HEADS * HEAD_DIM
SWA_KV_W = SWA_KV_HEADS * HEAD_DIM
FOX_W = FOX_HEADS * HEAD_DIM
D_MIX = SWA_Q_W + FOX_W
OFF_QA = SWA_Q_W
OFF_KA = OFF_QA + SWA_KV_W
OFF_VA = OFF_KA + SWA_KV_W
OFF_QB = OFF_VA + FOX_W
OFF_KB = OFF_QB + FOX_W
OFF_VB = OFF_KB + FOX_W
D_PROJ = OFF_VB + FOX_HEADS
WINDOW = 128
BLOCK = 128
N_BUCKETS = 32
MAX_DISTANCE = 128
D_FF = -(-8 * D_MODEL // (3 * 256)) * 256
EPS = 1e-6
NEG_INF = -1e30

kernel_name = "hymba_swa_sink_fox_t5bias_sandwich"


def rms_norm(x, g):
    xf = x.astype(jnp.float32)
    y = xf * lax.rsqrt(jnp.mean(xf * xf, axis=-1, keepdims=True) + EPS)
    return (y * g.astype(jnp.float32)).astype(x.dtype)


def t5_bucket(dist):
    n = jnp.maximum(dist, 0).astype(jnp.int32)
    max_exact = N_BUCKETS // 2
    nf = jnp.maximum(n, 1).astype(jnp.float32)
    large = max_exact + (jnp.log(nf / max_exact) / math.log(MAX_DISTANCE / max_exact)
                         * (N_BUCKETS - max_exact)).astype(jnp.int32)
    large = jnp.minimum(large, N_BUCKETS - 1)
    return jnp.where(n < max_exact, n, large)


def softmax_with_sink(s, sink):
    sink_r = sink.reshape((1,) + sink.shape + (1,) * (s.ndim - 3))
    col = jnp.broadcast_to(sink_r, s.shape[:-1] + (1,))
    p = jax.nn.softmax(jnp.concatenate([s, col], axis=-1), axis=-1)
    return p[..., :-1]


def swa_sink_attention(q, k, v, sinks, rel_bias):
    B, L = q.shape[0], q.shape[1]
    n_blk = (L - N_META) // BLOCK
    scale = HEAD_DIM ** -0.5
    sink = sinks.astype(jnp.float32).reshape(SWA_KV_HEADS, SWA_GROUP)
    tab = rel_bias.astype(jnp.float32)
    mi = jnp.arange(N_META)
    km, vm = k[:, :N_META], v[:, :N_META]

    qm = q[:, :N_META].reshape(B, N_META, SWA_KV_HEADS, SWA_GROUP, HEAD_DIM)
    d_mm = mi[:, None] - mi[None, :]
    b_mm = tab[t5_bucket(d_mm)].transpose(2, 0, 1).reshape(SWA_KV_HEADS, SWA_GROUP, N_META, N_META)
    s_mm = jnp.einsum('bqhgd,bkhd->bhgqk', qm, km, preferred_element_type=jnp.float32) * scale + b_mm
    s_mm = jnp.where(d_mm >= 0, s_mm, NEG_INF)
    p_mm = softmax_with_sink(s_mm, sink).astype(v.dtype)
    o_meta = jnp.einsum('bhgqk,bkhd->bqhgd', p_mm, vm).reshape(B, N_META, SWA_Q_HEADS, HEAD_DIM)

    qr = q[:, N_META:].reshape(B, n_blk, BLOCK, SWA_KV_HEADS, SWA_GROUP, HEAD_DIM)
    kr = k[:, N_META:].reshape(B, n_blk, BLOCK, SWA_KV_HEADS, HEAD_DIM)
    vr = v[:, N_META:].reshape(B, n_blk, BLOCK, SWA_KV_HEADS, HEAD_DIM)

    def with_prev(t):
        prev = jnp.pad(t, ((0, 0), (1, 0), (0, 0), (0, 0), (0, 0)))[:, :-1]
        return jnp.concatenate([prev, t], axis=2)

    kw, vw = with_prev(kr), with_prev(vr)
    qi = jnp.arange(BLOCK)[:, None]
    ki = jnp.arange(2 * BLOCK)[None, :]
    d_w = qi + BLOCK - ki
    b_w = tab[t5_bucket(d_w)].transpose(2, 0, 1).reshape(SWA_KV_HEADS, SWA_GROUP, 1, BLOCK, 2 * BLOCK)
    blk = jnp.arange(n_blk)[:, None, None]
    valid_w = ((d_w >= 0) & (d_w < WINDOW))[None] & ((blk > 0) | (ki >= BLOCK)[None])
    s_w = jnp.einsum('bnqhgd,bnkhd->bhgnqk', qr, kw, preferred_element_type=jnp.float32) * scale + b_w
    s_w = jnp.where(valid_w, s_w, NEG_INF)
    d_m = N_META + blk * BLOCK + qi[None] - mi[None, None, :]
    b_m = tab[t5_bucket(d_m)].transpose(3, 0, 1, 2).reshape(SWA_KV_HEADS, SWA_GROUP, n_blk, BLOCK, N_META)
    s_m = jnp.einsum('bnqhgd,bmhd->bhgnqm', qr, km, preferred_element_type=jnp.float32) * scale + b_m
    p = softmax_with_sink(jnp.concatenate([s_m, s_w], axis=-1), sink).astype(v.dtype)
    o = (jnp.einsum('bhgnqm,bmhd->bnqhgd', p[..., :N_META], vm)
         + jnp.einsum('bhgnqk,bnkhd->bnqhgd', p[..., N_META:], vw))
    o_real = o.reshape(B, n_blk * BLOCK, SWA_Q_HEADS, HEAD_DIM)
    return jnp.concatenate([o_meta, o_real], axis=1)


def forgetting_attention(q, k, v, f_logit):
    B, L = q.shape[0], q.shape[1]
    n_blk = (L - N_META) // BLOCK
    scale = HEAD_DIM ** -0.5
    cum = jnp.cumsum(jax.nn.log_sigmoid(f_logit.astype(jnp.float32)), axis=1).transpose(0, 2, 1)

    mi = jnp.arange(N_META)
    s = jnp.einsum('bqhd,bkhd->bhqk', q[:, :N_META], k[:, :N_META], preferred_element_type=jnp.float32) * scale
    s = s + cum[:, :, :N_META, None] - cum[:, :, None, :N_META]
    s = jnp.where(mi[:, None] >= mi[None, :], s, NEG_INF)
    p = jax.nn.softmax(s, axis=-1).astype(v.dtype)
    o_meta = jnp.einsum('bhqk,bkhd->bqhd', p, v[:, :N_META])

    qb = q[:, N_META:].reshape(B, n_blk, BLOCK, FOX_HEADS, HEAD_DIM).transpose(1, 0, 2, 3, 4)
    cb = cum[:, :, N_META:].reshape(B, FOX_HEADS, n_blk, BLOCK).transpose(2, 0, 1, 3)
    k_pos = jnp.arange(L)

    def one_block(args):
        q_blk, c_blk, b = args
        q_pos = N_META + b * BLOCK + jnp.arange(BLOCK)
        sb = jnp.einsum('bqhd,bkhd->bhqk', q_blk, k, preferred_element_type=jnp.float32) * scale
        sb = sb + c_blk[..., None] - cum[:, :, None, :]
        sb = jnp.where(k_pos[None, :] <= q_pos[:, None], sb, NEG_INF)
        pb = jax.nn.softmax(sb, axis=-1).astype(v.dtype)
        return jnp.einsum('bhqk,bkhd->bqhd', pb, v)

    o = lax.map(one_block, (qb, cb, jnp.arange(n_blk)))
    o_real = o.transpose(1, 0, 2, 3, 4).reshape(B, n_blk * BLOCK, FOX_HEADS, HEAD_DIM)
    return jnp.concatenate([o_meta, o_real], axis=1)


def setup_inputs(seed: int = 0) -> dict:
    key = jax.random.key(seed)
    ks = jax.random.split(key, 14)
    f32 = jnp.float32
    gain = lambda k: 1.0 + 0.05 * jax.random.normal(k, (DEPTH, D_MODEL), f32)
    return {
        "x": jax.random.normal(ks[0], (BATCH, SEQ, D_MODEL), f32),
        "meta_tokens": jax.random.normal(ks[1], (N_META, D_MODEL), f32),
        "rel_bias": 0.5 * jax.random.normal(ks[2], (N_BUCKETS, SWA_Q_HEADS), f32),
        "ln_pre_mix": gain(ks[3]),
        "ln_post_mix": gain(ks[4]),
        "ln_pre_ffn": gain(ks[5]),
        "ln_post_ffn": gain(ks[6]),
        "w_in": jax.random.normal(ks[7], (DEPTH, D_MODEL, D_PROJ), f32) * D_MODEL ** -0.5,
        "b_forget": jax.random.uniform(ks[8], (DEPTH, FOX_HEADS), f32, minval=1.0, maxval=5.0),
        "sinks": 0.5 * jax.random.normal(ks[9], (DEPTH, SWA_Q_HEADS), f32),
        "w_out": jax.random.normal(ks[10], (DEPTH, D_MIX, D_MODEL), f32) * D_MIX ** -0.5,
        "w_gate_up": jax.random.normal(ks[11], (DEPTH, D_MODEL, 2 * D_FF), f32) * D_MODEL ** -0.5,
        "w_down": jax.random.normal(ks[12], (DEPTH, D_FF, D_MODEL), f32) * D_FF ** -0.5,
    }


def reference(x, meta_tokens, rel_bias, ln_pre_mix, ln_post_mix, ln_pre_ffn, ln_post_ffn,
              w_in, b_forget, sinks, w_out, w_gate_up, w_down):
    B = x.shape[0]
    meta = jnp.broadcast_to(meta_tokens[None].astype(x.dtype), (B, N_META, D_MODEL))
    h = jnp.concatenate([meta, x], axis=1)
    L = h.shape[1]
    for layer in range(DEPTH):
        hn = rms_norm(h, ln_pre_mix[layer])
        proj = jnp.einsum('bld,dc->blc', hn, w_in[layer])
        q_a = proj[..., :OFF_QA].reshape(B, L, SWA_Q_HEADS, HEAD_DIM)
        k_a = proj[..., OFF_QA:OFF_KA].reshape(B, L, SWA_KV_HEADS, HEAD_DIM)
        v_a = proj[..., OFF_KA:OFF_VA].reshape(B, L, SWA_KV_HEADS, HEAD_DIM)
        q_b = proj[..., OFF_VA:OFF_QB].reshape(B, L, FOX_HEADS, HEAD_DIM)
        k_b = proj[..., OFF_QB:OFF_KB].reshape(B, L, FOX_HEADS, HEAD_DIM)
        v_b = proj[..., OFF_KB:OFF_VB].reshape(B, L, FOX_HEADS, HEAD_DIM)
        f_b = proj[..., OFF_VB:] + b_forget[layer].astype(proj.dtype)
        o_a = swa_sink_attention(q_a, k_a, v_a, sinks[layer], rel_bias)
        o_b = forgetting_attention(q_b, k_b, v_b, f_b)
        mix = jnp.concatenate([o_a.reshape(B, L, SWA_Q_W), o_b.reshape(B, L, FOX_W)], axis=-1)
        h = h + rms_norm(jnp.einsum('blc,cd->bld', mix, w_out[layer]), ln_post_mix[layer])
        hn = rms_norm(h, ln_pre_ffn[layer])
        gu = jnp.einsum('bld,df->blf', hn, w_gate_up[layer])
        ff = jnp.einsum('blf,fd->bld', jax.nn.silu(gu[..., :D_FF]) * gu[..., D_FF:], w_down[layer])
        h = h + rms_norm(ff, ln_post_ffn[layer])
    return h[:, N_META:]
```

```cpp
#include <hip/hip_runtime.h>
#include <cstdio>
#include <cstdint>

constexpr int BATCH = 4, SEQ = 4096, DM = 1024, NMETA = 16;
constexpr int M = BATCH * SEQ;
constexpr int LP = 4160;
constexpr int MP = BATCH * LP;
constexpr int NPJ = 2304;
constexpr int LDW_IN = 2312;
constexpr int OFF_QA = 0, OFF_KA = 512, OFF_VA = 640, OFF_QB = 768, OFF_KB = 1280, OFF_VB = 1792;
constexpr int DFF = 2816;
constexpr float EPS = 1e-6f;
constexpr float LOG2E = 1.4426950408889634f;
constexpr float C2 = 0.125f * LOG2E;
constexpr int XN_ROWS = M + 256;

constexpr size_t MiB = 1u << 20;
constexpr size_t WS_CTL = 0;
constexpr size_t WS_W1T = 1 * MiB;
constexpr size_t WS_WOT = 6 * MiB;
constexpr size_t WS_WGUT = 8 * MiB;
constexpr size_t WS_WDT = 19 * MiB;
constexpr size_t WS_LS = 25 * MiB;
constexpr size_t WS_XCH = 26 * MiB;
constexpr size_t WS_XN = 28 * MiB;
constexpr size_t WS_PROJ = 61 * MiB;
constexpr size_t WS_MIX = 135 * MiB;
constexpr size_t WS_ACT = 61 * MiB;
constexpr size_t WS_T1 = 168 * MiB;
constexpr size_t WS_END = 256 * MiB;
static_assert(WS_PROJ + (size_t)MP * NPJ * 2 <= WS_MIX && WS_MIX + (size_t)M * DM * 2 <= WS_T1 && WS_ACT + (size_t)M * DFF * 2 <= WS_T1 && WS_T1 + (size_t)M * DM * 4 <= WS_END, "ws map");
static_assert(WS_XN + (size_t)XN_ROWS * DM * 2 <= WS_PROJ, "ws map");

typedef unsigned short bf16;
typedef short bf16x8 __attribute__((ext_vector_type(8)));
typedef float f32x4 __attribute__((ext_vector_type(4)));
typedef unsigned v4u __attribute__((ext_vector_type(4)));
#define LAS __attribute__((address_space(3)))

__device__ __forceinline__ unsigned f2bf(float f) { unsigned u = __builtin_bit_cast(unsigned, f); return (u + 0x7fffu + ((u >> 16) & 1u)) >> 16; }
__device__ __forceinline__ unsigned pk2(float lo, float hi) { return f2bf(lo) | (f2bf(hi) << 16); }
__device__ __forceinline__ float bf2f(unsigned short b) { return __builtin_bit_cast(float, (unsigned)b << 16); }
__device__ __forceinline__ float wave_sum(float v) {
#pragma unroll
    for (int o = 1; o < 64; o <<= 1) v += __shfl_xor(v, o);
    return v;
}
__device__ __forceinline__ int t5_bucket(int d) {
    if (d < 16) return d;
    int b = 16;
    b += (d >= 19) + (d >= 21) + (d >= 24) + (d >= 27) + (d >= 31) + (d >= 35) + (d >= 40) + (d >= 46) + (d >= 52) + (d >= 59) + (d >= 67) + (d >= 77) + (d >= 87) + (d >= 99) + (d >= 113);
    return b;
}

struct Params {
    const float* x; const float* meta; const float* rel_bias; const float* g_pre_mix; const float* g_post_mix; const float* g_pre_ffn; const float* g_post_ffn;
    const float* w_in; const float* b_forget; const float* sinks; const float* w_out; const float* w_gu; const float* w_down;
    float* out; unsigned char* ws;
};

__device__ __forceinline__ void p0_transpose_item(const float* W, int ldw, int k0, int n0, bf16* WT, int Kd, int dest_row0, LAS float* scr, int lane) {
#pragma unroll 8
    for (int i = 0; i < 32; ++i) { const int kk = 2 * i + (lane >> 5); scr[kk * 33 + (lane & 31)] = W[(size_t)(k0 + kk) * ldw + n0 + (lane & 31)]; }
    asm volatile("s_waitcnt lgkmcnt(0)" ::: "memory");
    const int c = lane & 7;
#pragma unroll
    for (int j = 0; j < 4; ++j) { const int n = (lane >> 3) + 8 * j; const LAS float* s = scr + (8 * c) * 33 + n;
        v4u o; o.x = pk2(s[0 * 33], s[1 * 33]); o.y = pk2(s[2 * 33], s[3 * 33]); o.z = pk2(s[4 * 33], s[5 * 33]); o.w = pk2(s[6 * 33], s[7 * 33]);
        *(v4u*)(WT + (size_t)(dest_row0 + n) * Kd + k0 + 8 * c) = o; }
    asm volatile("s_waitcnt lgkmcnt(0)" ::: "memory");
}
__device__ __forceinline__ float log_sigmoid(float f) { return fminf(f, 0.f) - log1pf(expf(-fabsf(f))); }

__device__ __forceinline__ void p0_prologue(const Params& P, int gw, int NGW, LAS float* scr, int lane) {
    unsigned char* ws = P.ws;
    bf16* W1T = (bf16*)(ws + WS_W1T); bf16* WOT = (bf16*)(ws + WS_WOT); bf16* WGUT = (bf16*)(ws + WS_WGUT); bf16* WDT = (bf16*)(ws + WS_WDT);
    bf16* XN = (bf16*)(ws + WS_XN); float* LS = (float*)(ws + WS_LS); bf16* PROJ = (bf16*)(ws + WS_PROJ);
    constexpr int I_1 = (DM / 64) * (NPJ / 32), I_O = (DM / 64) * (DM / 32), I_GU = (DM / 64) * (2 * DFF / 32), I_D = (DFF / 64) * (DM / 32);
    constexpr int NITEMS = I_1 + I_O + I_GU + I_D;
    for (int it = gw; it < NITEMS; it += NGW) {
        int r = it;
        if (r < I_1) { const int nb = NPJ / 32, kb = r / nb, n0 = 32 * (r % nb); p0_transpose_item(P.w_in, LDW_IN, 64 * kb, n0, W1T, DM, n0, scr, lane); continue; } r -= I_1;
        if (r < I_O) { const int nb = DM / 32, kb = r / nb, n0 = 32 * (r % nb); p0_transpose_item(P.w_out, DM, 64 * kb, n0, WOT, DM, n0, scr, lane); continue; } r -= I_O;
        if (r < I_GU) { const int nb = 2 * DFF / 32, kb = r / nb, n0 = 32 * (r % nb);
            const int up = n0 >= DFF, nn = up ? n0 - DFF : n0, dr = 256 * (nn / 128) + 128 * up + (nn % 128);
            p0_transpose_item(P.w_gu, 2 * DFF, 64 * kb, n0, WGUT, DM, dr, scr, lane); continue; } r -= I_GU;
        { const int nb = DM / 32, kb = r / nb, n0 = 32 * (r % nb); p0_transpose_item(P.w_down, DM, 64 * kb, n0, WDT, DFF, n0, scr, lane); }
    }
    float wf[16][8];
#pragma unroll
    for (int j = 0; j < 4; ++j)
#pragma unroll
        for (int e = 0; e < 4; ++e) { const float* wp = P.w_in + (size_t)(256 * j + 4 * lane + e) * LDW_IN + NPJ; const f32x4 a = *(const f32x4*)wp, b = *(const f32x4*)(wp + 4);
            wf[4 * j + e][0] = a.x; wf[4 * j + e][1] = a.y; wf[4 * j + e][2] = a.z; wf[4 * j + e][3] = a.w; wf[4 * j + e][4] = b.x; wf[4 * j + e][5] = b.y; wf[4 * j + e][6] = b.z; wf[4 * j + e][7] = b.w; }
    f32x4 g[4];
#pragma unroll
    for (int j = 0; j < 4; ++j) g[j] = *((const f32x4*)P.g_pre_mix + lane + 64 * j);
    float bfg = P.b_forget[lane & 7];
    for (int m = gw; m < M + NMETA; m += NGW) {
        const float* xrow = m < M ? P.x + (size_t)m * DM : P.meta + (size_t)(m - M) * DM;
        const f32x4* xr = (const f32x4*)xrow + lane;
        f32x4 v[4]; float s = 0.f;
#pragma unroll
        for (int j = 0; j < 4; ++j) { v[j] = xr[64 * j]; s += (v[j].x * v[j].x + v[j].y * v[j].y) + (v[j].z * v[j].z + v[j].w * v[j].w); }
        const float rstd = 1.f / sqrtf(wave_sum(s) * (1.f / DM) + EPS);
        float f[8];
#pragma unroll
        for (int c = 0; c < 8; ++c) f[c] = 0.f;
        unsigned long long* o8 = (unsigned long long*)(XN + (size_t)m * DM) + lane;
#pragma unroll
        for (int j = 0; j < 4; ++j) { v[j] = v[j] * rstd * g[j];
#pragma unroll
            for (int c = 0; c < 8; ++c) f[c] += v[j].x * wf[4 * j][c] + v[j].y * wf[4 * j + 1][c] + v[j].z * wf[4 * j + 2][c] + v[j].w * wf[4 * j + 3][c];
            o8[64 * j] = (unsigned long long)pk2(v[j].x, v[j].y) | ((unsigned long long)pk2(v[j].z, v[j].w) << 32); }
        float fs = 0.f;
#pragma unroll
        for (int c = 0; c < 8; ++c) { const float t = wave_sum(f[c]); fs = ((lane & 7) == c) ? t : fs; }
        const float ls = log_sigmoid(fs + bfg);
        if (m < M) { if (lane < 8) LS[(size_t)(m + 64 + 64 * (m >> 12)) * 8 + lane] = ls; }
        else { if (lane < 32) LS[(size_t)((lane >> 3) * LP + 48 + (m - M)) * 8 + (lane & 7)] = ls; }
    }
    for (int m = M + NMETA + gw; m < XN_ROWS; m += NGW) { unsigned long long* o8 = (unsigned long long*)(XN + (size_t)m * DM) + lane;
#pragma unroll
        for (int j = 0; j < 4; ++j) o8[64 * j] = 0ull; }
    for (int i = gw; i < BATCH * 48; i += NGW) { const int row = (i / 48) * LP + (i % 48);
        if (lane < 8) LS[(size_t)row * 8 + lane] = 0.f;
        v4u* pr = (v4u*)(PROJ + (size_t)row * NPJ);
        for (int c = lane; c < NPJ / 8; c += 64) pr[c] = (v4u){0u, 0u, 0u, 0u}; }
}
__global__ void __launch_bounds__(256) k_prologue(Params P) {
    __shared__ float scr_all[4 * 64 * 33];
    const int lane = threadIdx.x & 63, wave = threadIdx.x >> 6;
    p0_prologue(P, blockIdx.x * 4 + wave, gridDim.x * 4, (LAS float*)scr_all + wave * 64 * 33, lane);
}

template <int MODE>
__global__ void __launch_bounds__(256) k_gemm_base(const bf16* A, const bf16* Bt, int K, int nbn, unsigned char* ws) {
    const int lane = threadIdx.x & 63, wave = threadIdx.x >> 6, wm = wave >> 1, wn = wave & 1;
    const int bm = blockIdx.x / nbn, bn = blockIdx.x % nbn;
    const int l15 = lane & 15, lq = lane >> 4;
    f32x4 acc[4][4];
#pragma unroll
    for (int i = 0; i < 4; ++i)
#pragma unroll
        for (int j = 0; j < 4; ++j) acc[i][j] = (f32x4){0.f, 0.f, 0.f, 0.f};
    const int arow0 = bm * 128 + wm * 64;
    int brow[4];
#pragma unroll
    for (int n = 0; n < 4; ++n) {
        if (MODE == 2) brow[n] = (bn >> 1) * 256 + (n >> 1) * 128 + (bn & 1) * 64 + wn * 32 + (n & 1) * 16 + l15;
        else brow[n] = bn * 128 + wn * 64 + n * 16 + l15;
    }
    for (int k0 = 0; k0 < K; k0 += 32) {
        bf16x8 a[4], b[4];
#pragma unroll
        for (int m = 0; m < 4; ++m) a[m] = *(const bf16x8*)(A + (size_t)(arow0 + m * 16 + l15) * K + k0 + 8 * lq);
#pragma unroll
        for (int n = 0; n < 4; ++n) b[n] = *(const bf16x8*)(Bt + (size_t)brow[n] * K + k0 + 8 * lq);
#pragma unroll
        for (int m = 0; m < 4; ++m)
#pragma unroll
            for (int n = 0; n < 4; ++n) acc[m][n] = __builtin_amdgcn_mfma_f32_16x16x32_bf16(a[m], b[n], acc[m][n], 0, 0, 0);
    }
    if (MODE == 0) {
        bf16* PROJ = (bf16*)(ws + WS_PROJ);
#pragma unroll
        for (int m = 0; m < 4; ++m)
#pragma unroll
            for (int n = 0; n < 4; ++n)
#pragma unroll
                for (int r = 0; r < 4; ++r) {
                    const int row = arow0 + m * 16 + 4 * lq + r, col = bn * 128 + wn * 64 + n * 16 + l15;
                    float v = acc[m][n][r]; if (col < OFF_KA || (col >= OFF_QB && col < OFF_KB)) v *= C2;
                    const bf16 o = (bf16)f2bf(v);
                    if (row < M) PROJ[(size_t)(row + 64 + 64 * (row >> 12)) * NPJ + col] = o;
                    else if (row < M + NMETA) { for (int b = 0; b < BATCH; ++b) PROJ[(size_t)(b * LP + 48 + (row - M)) * NPJ + col] = o; }
                }
    } else if (MODE == 1) {
        float* T1 = (float*)(ws + WS_T1);
#pragma unroll
        for (int m = 0; m < 4; ++m)
#pragma unroll
            for (int n = 0; n < 4; ++n)
#pragma unroll
                for (int r = 0; r < 4; ++r) {
                    const int row = arow0 + m * 16 + 4 * lq + r, col = bn * 128 + wn * 64 + n * 16 + l15;
                    T1[(size_t)row * (nbn * 128) + col] = acc[m][n][r];
                }
    } else {
        bf16* ACT = (bf16*)(ws + WS_ACT);
#pragma unroll
        for (int m = 0; m < 4; ++m)
#pragma unroll
            for (int n = 0; n < 2; ++n)
#pragma unroll
                for (int r = 0; r < 4; ++r) {
                    const int row = arow0 + m * 16 + 4 * lq + r, col = bn * 64 + wn * 32 + n * 16 + l15;
                    const float gt = acc[m][n][r], up = acc[m][n + 2][r];
                    const float a = gt / (1.f + __expf(-gt)) * up;
                    ACT[(size_t)row * DFF + col] = (bf16)f2bf(a);
                }
    }
}

template <bool FOX>
__global__ void __launch_bounds__(64) k_attn_base(Params P) {
    const bf16* PROJ = (const bf16*)(P.ws + WS_PROJ); const float* LS = (const float*)(P.ws + WS_LS); bf16* MIX = (bf16*)(P.ws + WS_MIX);
    const int blk = blockIdx.x;
    const int chunk = blk % 64, h = (blk / 64) % 8, b = blk / 512;
    const int r = chunk * 64 + threadIdx.x;
    const int Rq = 64 + r;
    const bf16* base = PROJ + (size_t)b * LP * NPJ;
    const int qoff = FOX ? OFF_QB + 64 * h : OFF_QA + 64 * h;
    const int koff = FOX ? OFF_KB + 64 * h : OFF_KA + 64 * (h >> 2);
    const int voff = FOX ? OFF_VB + 64 * h : OFF_VA + 64 * (h >> 2);
    float q[64], o[64];
#pragma unroll
    for (int d = 0; d < 64; ++d) { q[d] = bf2f(base[(size_t)Rq * NPJ + qoff + d]); o[d] = 0.f; }
    float mx = -1e30f, l = 0.f, c = 0.f;
    const int kend = 64 + chunk * 64 + 63;
    const int kstart = FOX ? 48 : 48;
    for (int k = kstart; k <= kend; ++k) {
        if (!FOX && k >= 64 && k < 64 + chunk * 64 - 127) { k = 64 + chunk * 64 - 127 - 1; continue; }
        float bias; bool valid;
        if (FOX) { c += LS[(size_t)(b * LP + k) * 8 + h]; bias = -c * LOG2E; valid = k <= Rq; }
        else { const int d = Rq - k; valid = (k < 64) || (d >= 0 && d < 128); bias = valid ? P.rel_bias[t5_bucket(d) * 8 + h] * LOG2E : 0.f; }
        const bf16x8* kr = (const bf16x8*)(base + (size_t)k * NPJ + koff);
        float s = 0.f;
#pragma unroll
        for (int j = 0; j < 8; ++j) { const bf16x8 kv = kr[j];
#pragma unroll
            for (int e = 0; e < 8; ++e) s += q[8 * j + e] * bf2f((unsigned short)kv[e]); }
        s += bias;
        if (valid) {
            const float mn = fmaxf(mx, s), f = exp2f(mx - mn), p = exp2f(s - mn);
            l = l * f + p; mx = mn;
            const bf16x8* vr = (const bf16x8*)(base + (size_t)k * NPJ + voff);
#pragma unroll
            for (int j = 0; j < 8; ++j) { const bf16x8 vv = vr[j];
#pragma unroll
                for (int e = 0; e < 8; ++e) o[8 * j + e] = o[8 * j + e] * f + p * bf2f((unsigned short)vv[e]); }
        }
    }
    if (!FOX) l += exp2f(P.sinks[h] * LOG2E - mx);
    const float rl = 1.f / l;
    bf16* orow = MIX + (size_t)(b * SEQ + r) * DM + (FOX ? 512 : 0) + 64 * h;
#pragma unroll
    for (int d = 0; d < 64; d += 2) *(unsigned*)(orow + d) = pk2(o[d] * rl, o[d + 1] * rl);
}

__global__ void __launch_bounds__(256) k_post1(Params P) {
    const int lane = threadIdx.x & 63, row = blockIdx.x * 4 + (threadIdx.x >> 6);
    const f32x4* t = (const f32x4*)((const float*)(P.ws + WS_T1) + (size_t)row * DM) + lane;
    const f32x4* xr = (const f32x4*)(P.x + (size_t)row * DM) + lane;
    f32x4 v[4]; float s = 0.f;
#pragma unroll
    for (int j = 0; j < 4; ++j) { v[j] = t[64 * j]; s += (v[j].x * v[j].x + v[j].y * v[j].y) + (v[j].z * v[j].z + v[j].w * v[j].w); }
    const float rstd = 1.f / sqrtf(wave_sum(s) * (1.f / DM) + EPS);
    float s2 = 0.f;
#pragma unroll
    for (int j = 0; j < 4; ++j) { const f32x4 g = *((const f32x4*)P.g_post_mix + lane + 64 * j); v[j] = xr[64 * j] + v[j] * rstd * g; s2 += (v[j].x * v[j].x + v[j].y * v[j].y) + (v[j].z * v[j].z + v[j].w * v[j].w); }
    const float rstd2 = 1.f / sqrtf(wave_sum(s2) * (1.f / DM) + EPS);
    f32x4* orow = (f32x4*)(P.out + (size_t)row * DM) + lane;
    unsigned long long* o8 = (unsigned long long*)((bf16*)(P.ws + WS_XN) + (size_t)row * DM) + lane;
#pragma unroll
    for (int j = 0; j < 4; ++j) { orow[64 * j] = v[j]; const f32x4 g = *((const f32x4*)P.g_pre_ffn + lane + 64 * j); const f32x4 w = v[j] * rstd2 * g;
        o8[64 * j] = (unsigned long long)pk2(w.x, w.y) | ((unsigned long long)pk2(w.z, w.w) << 32); }
}
__global__ void __launch_bounds__(256) k_post2(Params P) {
    const int lane = threadIdx.x & 63, row = blockIdx.x * 4 + (threadIdx.x >> 6);
    const f32x4* t = (const f32x4*)((const float*)(P.ws + WS_T1) + (size_t)row * DM) + lane;
    f32x4* orow = (f32x4*)(P.out + (size_t)row * DM) + lane;
    f32x4 v[4]; float s = 0.f;
#pragma unroll
    for (int j = 0; j < 4; ++j) { v[j] = t[64 * j]; s += (v[j].x * v[j].x + v[j].y * v[j].y) + (v[j].z * v[j].z + v[j].w * v[j].w); }
    const float rstd = 1.f / sqrtf(wave_sum(s) * (1.f / DM) + EPS);
#pragma unroll
    for (int j = 0; j < 4; ++j) { const f32x4 g = *((const f32x4*)P.g_post_ffn + lane + 64 * j); orow[64 * j] = orow[64 * j] + v[j] * rstd * g; }
}

extern "C" void kernel_launch(void* const* d_in, const int* in_sizes, int n_in, void* d_out, int out_size, void* d_ws, size_t ws_size, hipStream_t stream) {
    if (n_in != 13 || in_sizes[0] != M * DM || out_size != M * DM || ws_size < WS_END) { fprintf(stderr, "kernel_launch: unexpected shapes (n_in %d, in0 %d, out %d, ws %zu)\n", n_in, n_in > 0 ? in_sizes[0] : -1, out_size, ws_size); return; }
    Params P{};
    P.x = (const float*)d_in[0]; P.meta = (const float*)d_in[1]; P.rel_bias = (const float*)d_in[2]; P.g_pre_mix = (const float*)d_in[3]; P.g_post_mix = (const float*)d_in[4];
    P.g_pre_ffn = (const float*)d_in[5]; P.g_post_ffn = (const float*)d_in[6]; P.w_in = (const float*)d_in[7]; P.b_forget = (const float*)d_in[8]; P.sinks = (const float*)d_in[9];
    P.w_out = (const float*)d_in[10]; P.w_gu = (const float*)d_in[11]; P.w_down = (const float*)d_in[12]; P.out = (float*)d_out; P.ws = (unsigned char*)d_ws;
    unsigned char* ws = (unsigned char*)d_ws;
    hipLaunchKernelGGL(k_prologue, dim3(1024), dim3(256), 0, stream, P);
    hipLaunchKernelGGL(k_gemm_base<0>, dim3((XN_ROWS / 128 - 1) * (NPJ / 128)), dim3(256), 0, stream, (const bf16*)(ws + WS_XN), (const bf16*)(ws + WS_W1T), DM, NPJ / 128, ws);
    hipLaunchKernelGGL(k_attn_base<false>, dim3(BATCH * 8 * 64), dim3(64), 0, stream, P);
    hipLaunchKernelGGL(k_attn_base<true>, dim3(BATCH * 8 * 64), dim3(64), 0, stream, P);
    hipLaunchKernelGGL(k_gemm_base<1>, dim3((M / 128) * (DM / 128)), dim3(256), 0, stream, (const bf16*)(ws + WS_MIX), (const bf16*)(ws + WS_WOT), DM, DM / 128, ws);
    hipLaunchKernelGGL(k_post1, dim3(M / 4), dim3(256), 0, stream, P);
    hipLaunchKernelGGL(k_gemm_base<2>, dim3((M / 128) * (DFF / 64)), dim3(256), 0, stream, (const bf16*)(ws + WS_XN), (const bf16*)(ws + WS_WGUT), DM, DFF / 64, ws);
    hipLaunchKernelGGL(k_gemm_base<1>, dim3((M / 128) * (DM / 128)), dim3(256), 0, stream, (const bf16*)(ws + WS_ACT), (const bf16*)(ws + WS_WDT), DFF, DM / 128, ws);
    hipLaunchKernelGGL(k_post2, dim3(M / 4), dim3(256), 0, stream, P);
}
```
